# Optimizing an MI355X kernel written in HIP

```python
import jax, jax.numpy as jnp
from jax import lax
import numpy as np

D_MODEL = 1024
BATCH = 4
SEQ = 8192
DEPTH = 1

PLE_DIM = 256
MLA_HEADS = 4
QK_NOPE_DIM = 128
QK_ROPE_DIM = 64
QK_HEAD_DIM = QK_NOPE_DIM + QK_ROPE_DIM
V_HEAD_DIM = 128
Q_LORA_RANK = 256
KV_LORA_RANK = 128
ROPE_THETA = 10000.0
MLA_WIDTH = MLA_HEADS * V_HEAD_DIM
Q_BLOCK = 128
MLSTM_HEADS = 4
MLSTM_HEAD_DIM = 128
MLSTM_WIDTH = MLSTM_HEADS * MLSTM_HEAD_DIM
CONV_WIDTH = 4
CHUNK = 64
D_MIX = MLA_WIDTH + MLSTM_WIDTH
IN_SIZES = (Q_LORA_RANK, KV_LORA_RANK, QK_ROPE_DIM, MLSTM_WIDTH, MLSTM_WIDTH, MLSTM_WIDTH, MLSTM_WIDTH, MLSTM_HEADS, MLSTM_HEADS)
D_IN = sum(IN_SIZES)
D_FF = ((8 * D_MODEL + 3 * 256 - 1) // (3 * 256)) * 256
EPS = 1e-6

kernel_name = "hymba_mla_mlstm_layer"


def rms_norm(x, g):
    xf = x.astype(jnp.float32)
    y = xf * lax.rsqrt(jnp.mean(xf * xf, axis=-1, keepdims=True) + EPS)
    return (y * g.astype(jnp.float32)).astype(x.dtype)


def split_cols(z, sizes):
    offs = np.cumsum(sizes)[:-1].tolist()
    return jnp.split(z, offs, axis=-1)


def rope_cos_sin(positions):
    inv_freq = ROPE_THETA ** (-jnp.arange(0, QK_ROPE_DIM, 2, dtype=jnp.float32) / QK_ROPE_DIM)
    ang = positions.astype(jnp.float32)[..., None] * inv_freq
    return jnp.cos(ang), jnp.sin(ang)


def apply_rope(t, cos, sin):
    tf = t.astype(jnp.float32)
    t1, t2 = tf[..., :QK_ROPE_DIM // 2], tf[..., QK_ROPE_DIM // 2:]
    return jnp.concatenate([t1 * cos - t2 * sin, t2 * cos + t1 * sin], axis=-1).astype(t.dtype)


def causal_mla(q, k, v):
    B, S, H, _ = q.shape
    nb = S // Q_BLOCK
    qb = (q * (QK_HEAD_DIM ** -0.5)).reshape(B, nb, Q_BLOCK, H, QK_HEAD_DIM).transpose(1, 0, 3, 2, 4)
    key_pos = jnp.arange(S)

    def one_block(args):
        q_blk, blk = args
        s = jnp.einsum('bhqd,bkhd->bhqk', q_blk, k).astype(jnp.float32)
        q_pos = blk * Q_BLOCK + jnp.arange(Q_BLOCK)
        s = jnp.where(key_pos[None, :] <= q_pos[:, None], s, -jnp.inf)
        pr = jax.nn.softmax(s, axis=-1).astype(v.dtype)
        return jnp.einsum('bhqk,bkhv->bqhv', pr, v)

    out = lax.map(one_block, (qb, jnp.arange(nb)))
    return out.transpose(1, 0, 2, 3, 4).reshape(B, S, H * V_HEAD_DIM)


def causal_dwconv(t, w, b):
    S = t.shape[1]
    tp = jnp.pad(t, ((0, 0), (CONV_WIDTH - 1, 0), (0, 0)))
    acc = b
    for j in range(CONV_WIDTH):
        acc = acc + w[j] * tp[:, j:j + S]
    return acc


def mlstm_chunkwise(q, k, v, i_pre, f_pre):
    out_dtype = q.dtype
    B, S, NH, DH = q.shape
    nc = S // CHUNK
    f32 = jnp.float32

    def chunks4(t):
        return t.astype(f32).reshape(B, nc, CHUNK, NH, DH).transpose(1, 0, 3, 2, 4)

    def chunks3(t):
        return t.astype(f32).reshape(B, nc, CHUNK, NH).transpose(1, 0, 3, 2)

    qc_all = chunks4(q)
    kc_all = chunks4(k) * (DH ** -0.5)
    vc_all = chunks4(v)
    ic_all = chunks3(i_pre)
    fc_all = jax.nn.log_sigmoid(chunks3(f_pre))
    tril = jnp.tril(jnp.ones((CHUNK, CHUNK), dtype=bool))

    def step(carry, xs):
        C, n, m = carry
        qc, kc, vc, ic, fc = xs
        b = jnp.cumsum(fc, axis=-1)
        g = b[..., -1]
        d = b[..., :, None] - b[..., None, :] + ic[..., None, :]
        d = jnp.where(tril, d, -jnp.inf)
        m_inter = b + m[..., None]
        m_j = jnp.maximum(m_inter, d.max(axis=-1))
        s = jnp.einsum('bhld,bhsd->bhls', qc, kc) * jnp.exp(d - m_j[..., None])
        inter = jnp.exp(m_inter - m_j)
        num = jnp.einsum('bhls,bhsv->bhlv', s, vc) + inter[..., None] * jnp.einsum('bhld,bhdv->bhlv', qc, C)
        den = s.sum(axis=-1) + inter * jnp.einsum('bhld,bhd->bhl', qc, n)
        h = num / jnp.maximum(jnp.abs(den), jnp.exp(-m_j))[..., None]
        a = g[..., None] - b + ic
        m_new = jnp.maximum(g + m, a.max(axis=-1))
        decay = jnp.exp(g + m - m_new)
        w = jnp.exp(a - m_new[..., None])
        C_new = decay[..., None, None] * C + jnp.einsum('bhs,bhsd,bhsv->bhdv', w, kc, vc)
        n_new = decay[..., None] * n + jnp.einsum('bhs,bhsd->bhd', w, kc)
        return (C_new, n_new, m_new), h

    init = (jnp.zeros((B, NH, DH, DH), f32), jnp.zeros((B, NH, DH), f32), jnp.zeros((B, NH), f32))
    _, h = lax.scan(step, init, (qc_all, kc_all, vc_all, ic_all, fc_all))
    return h.transpose(1, 0, 3, 2, 4).reshape(B, S, NH, DH).astype(out_dtype)


def setup_inputs(seed: int = 0) -> dict:
    key = jax.random.key(seed)
    ks = jax.random.split(key, 26)
    f32 = jnp.float32

    def nrm(k, shape, scale):
        return jax.random.normal(k, shape, f32) * scale

    def gain(k, shape):
        return 1.0 + 0.05 * jax.random.normal(k, shape, f32)

    L = DEPTH
    x = nrm(ks[0], (BATCH, SEQ, D_MODEL), 1.0)
    p = nrm(ks[1], (DEPTH, BATCH, SEQ, PLE_DIM), 1.0)
    offset = jax.random.randint(ks[2], (BATCH, 1), 0, 1024, dtype=jnp.int32)
    positions = (offset + jnp.arange(SEQ, dtype=jnp.int32)[None, :]).astype(jnp.int32)
    return {
        "x": x,
        "p": p,
        "positions": positions,
        "attn_pre_norm": gain(ks[3], (L, D_MODEL)),
        "attn_post_norm": gain(ks[4], (L, D_MODEL)),
        "w_in": nrm(ks[5], (L, D_MODEL, D_IN), D_MODEL ** -0.5),
        "q_norm": gain(ks[6], (L, Q_LORA_RANK)),
        "kv_norm": gain(ks[7], (L, KV_LORA_RANK)),
        "w_uq": nrm(ks[8], (L, Q_LORA_RANK, MLA_HEADS * QK_HEAD_DIM), Q_LORA_RANK ** -0.5),
        "w_ukv": nrm(ks[9], (L, KV_LORA_RANK, MLA_HEADS * (QK_NOPE_DIM + V_HEAD_DIM)), KV_LORA_RANK ** -0.5),
        "conv_w": nrm(ks[10], (L, CONV_WIDTH, 2 * MLSTM_WIDTH), CONV_WIDTH ** -0.5),
        "conv_b": nrm(ks[11], (L, 2 * MLSTM_WIDTH), 0.02),
        "gate_bias_i": nrm(ks[12], (L, MLSTM_HEADS), 0.1),
        "gate_bias_f": 3.0 + nrm(ks[13], (L, MLSTM_HEADS), 0.5),
        "mlstm_norm": gain(ks[14], (L, MLSTM_WIDTH)),
        "w_out": nrm(ks[15], (L, D_MIX, D_MODEL), D_MIX ** -0.5),
        "ffn_pre_norm": gain(ks[16], (L, D_MODEL)),
        "ffn_post_norm": gain(ks[17], (L, D_MODEL)),
        "w_gate": nrm(ks[18], (L, D_MODEL, D_FF), D_MODEL ** -0.5),
        "w_up": nrm(ks[19], (L, D_MODEL, D_FF), D_MODEL ** -0.5),
        "w_down": nrm(ks[20], (L, D_FF, D_MODEL), D_FF ** -0.5),
        "w_ple_proj": nrm(ks[21], (L, PLE_DIM, D_MODEL), PLE_DIM ** -0.5),
        "w_ple_gate": nrm(ks[22], (L, D_MODEL, D_MODEL), D_MODEL ** -0.5),
    }


def reference(x, p, positions, attn_pre_norm, attn_post_norm, w_in, q_norm, kv_norm, w_uq, w_ukv,
              conv_w, conv_b, gate_bias_i, gate_bias_f, mlstm_norm, w_out, ffn_pre_norm, ffn_post_norm,
              w_gate, w_up, w_down, w_ple_proj, w_ple_gate):
    B, S, _ = x.shape
    cos, sin = rope_cos_sin(positions)
    hd = (B, S, MLSTM_HEADS, MLSTM_HEAD_DIM)
    h = x
    for i in range(DEPTH):
        u = rms_norm(h, attn_pre_norm[i])
        c_q, c_kv, k_rope, m_q, m_k, m_v, m_o, m_i, m_f = split_cols(u @ w_in[i], IN_SIZES)

        q = (rms_norm(c_q, q_norm[i]) @ w_uq[i]).reshape(B, S, MLA_HEADS, QK_HEAD_DIM)
        kv = (rms_norm(c_kv, kv_norm[i]) @ w_ukv[i]).reshape(B, S, MLA_HEADS, QK_NOPE_DIM + V_HEAD_DIM)
        q_nope, q_pe = q[..., :QK_NOPE_DIM], q[..., QK_NOPE_DIM:]
        k_nope, v = kv[..., :QK_NOPE_DIM], kv[..., QK_NOPE_DIM:]
        q_pe = apply_rope(q_pe, cos[:, :, None], sin[:, :, None])
        k_pe = apply_rope(k_rope, cos, sin)[:, :, None]
        q = jnp.concatenate([q_nope, q_pe], axis=-1)
        k = jnp.concatenate([k_nope, jnp.broadcast_to(k_pe, (B, S, MLA_HEADS, QK_ROPE_DIM))], axis=-1)
        mla_out = causal_mla(q, k, v)

        qk = jax.nn.silu(causal_dwconv(jnp.concatenate([m_q, m_k], axis=-1), conv_w[i], conv_b[i]))
        mq, mk = qk[..., :MLSTM_WIDTH], qk[..., MLSTM_WIDTH:]
        hm = mlstm_chunkwise(mq.reshape(hd), mk.reshape(hd), m_v.reshape(hd),
                             m_i + gate_bias_i[i], m_f + gate_bias_f[i])
        hm = rms_norm(hm, mlstm_norm[i].reshape(MLSTM_HEADS, MLSTM_HEAD_DIM)).reshape(B, S, MLSTM_WIDTH)
        mlstm_out = jax.nn.sigmoid(m_o) * hm

        mix = jnp.concatenate([mla_out, mlstm_out], axis=-1) @ w_out[i]
        h = h + rms_norm(mix, attn_post_norm[i])

        f = rms_norm(h, ffn_pre_norm[i])
        f = (jax.nn.silu(f @ w_gate[i]) * (f @ w_up[i])) @ w_down[i]
        h = h + rms_norm(f, ffn_post_norm[i])

        h = h + jax.nn.sigmoid(h @ w_ple_gate[i]) * (p[i] @ w_ple_proj[i])
    return h
```

```cpp
#include <hip/hip_runtime.h>
#include <cstdio>
#include <cstdint>

constexpr int BATCH = 4, SEQ = 8192, DM = 1024, MTOK = BATCH * SEQ;
constexpr int PLE = 256, NHD = 4, QKD = 192, VDIM = 128;
constexpr int DIN = 2504, NZ = 2560, DFF = 2816, MLW = 512;
constexpr int NCH = SEQ / 64;
constexpr float EPS = 1e-6f;
constexpr float LOG2E = 1.4426950408889634f;
constexpr float QSCALE = 0.07216878364870322f * LOG2E;
constexpr float KSCALE_ML = 0.08838834764831845f;

namespace pg8 {
#define PG8_LAS __attribute__((address_space(3)))
typedef unsigned short bf16_t;
typedef short bf16x8 __attribute__((ext_vector_type(8)));
typedef float f32x4 __attribute__((ext_vector_type(4)));
typedef unsigned u32x4 __attribute__((ext_vector_type(4)));
constexpr int BM = 256, BK = 64, HALF = 128, HTB = HALF * BK * 2  , STAGE_BYTES = 8 * HTB, NXCD = 8, WGM = 8;

__host__ __device__ __forceinline__ int lds_byte(int r, int c) { const int st = (r >> 4) * 2 + (c >> 5), rr = r & 15, cc = c & 31, ob = rr * 64 + cc * 2; return st * 1024 + (ob ^ (((ob >> 9) & 1) << 5)); }
__host__ __device__ __forceinline__ void stage_rc(int b, int& R, int& C) { const int st = b / 1024, sb = b % 1024, swz = sb ^ (((sb >> 9) & 1) << 5); R = (st >> 1) * 16 + swz / 64; C = (st & 1) * 32 + (swz % 64) / 2; }
__host__ __device__ __forceinline__ int perm32(int rho) { const int n = rho >> 4, i = rho & 15; return 8 * (i >> 2) + 4 * n + (i & 3); }

struct Unit { int pm, pn; };
struct Gemm { const bf16_t* A; const bf16_t* Bt; int M, N, K, lda; };

struct StaticOrder {
    int nM, nN, nwg, G, c;
    __host__ __device__ void init(int M, int N, int G_, int c_) { nM = M / BM; nN = N / BM; nwg = nM * nN; G = G_; c = c_; }
    __host__ __device__ bool next(int i, Unit& u) const {
        const long L = (long)i * G + c; if (L >= nwg) return false;
        int wgid = (int)L; { const int q = nwg / NXCD, r = nwg % NXCD, xcd = wgid % NXCD, off = wgid / NXCD; wgid = (xcd < r ? xcd * (q + 1) : r * (q + 1) + (xcd - r) * q) + off; }
        const int nig = WGM * nN, gid = wgid / nig, fm = gid * WGM, gsz = (nM - fm) < WGM ? (nM - fm) : WGM;
        u.pm = fm + ((wgid % nig) % gsz); u.pn = (wgid % nig) / gsz; return true;
    }
    __device__ __forceinline__ void a_ready(const Unit&) const {}
    __device__ __forceinline__ void done(const Unit&) const {}
};

__device__ __forceinline__ unsigned cvt_pk_bf16(float lo, float hi) { unsigned r; asm volatile("v_cvt_pk_bf16_f32 %0, %1, %2" : "=v"(r) : "v"(lo), "v"(hi)); return r; }
typedef unsigned u32x2 __attribute__((ext_vector_type(2)));
__device__ __forceinline__ u32x4 pack8(f32x4 a, f32x4 b) { u32x4 w; w.x = cvt_pk_bf16(a[0], a[1]); w.y = cvt_pk_bf16(a[2], a[3]); w.z = cvt_pk_bf16(b[0], b[1]); w.w = cvt_pk_bf16(b[2], b[3]); return w; }
__device__ __forceinline__ float bf_lo(unsigned w) { return __uint_as_float(w << 16); }
__device__ __forceinline__ float bf_hi(unsigned w) { return __uint_as_float(w & 0xffff0000u); }
__device__ __forceinline__ float sigmoid_f(float x) { return __builtin_amdgcn_rcpf(1.f + __builtin_amdgcn_exp2f(-x * 1.4426950408889634f)); }

struct EpiStore {
    static constexpr bool PERM = true, AFTER_DRAIN = false;
    bf16_t* O; int ldc;
    __device__ __forceinline__ void operator()(const f32x4 (&acc)[2][2][4][2], const Unit& u, int wr, int wc, int fr, int fq) const {
        const int row0 = u.pm * BM + wr * 64 + fr, col0 = u.pn * BM + wc * 32 + 8 * fq;
#pragma unroll
        for (int ai = 0; ai < 2; ++ai)
#pragma unroll
            for (int m = 0; m < 4; ++m) { bf16_t* rowp = O + (size_t)(row0 + ai * HALF + m * 16) * ldc + col0;
#pragma unroll
                for (int bj = 0; bj < 2; ++bj) *(u32x4*)(rowp + bj * HALF) = pack8(acc[ai][bj][m][0], acc[ai][bj][m][1]); }
    }
};
struct EpiZ {
    static constexpr bool PERM = true, AFTER_DRAIN = false;
    bf16_t* ZA; bf16_t* ZM; float* ZAF;
    __device__ __forceinline__ void operator()(const f32x4 (&acc)[2][2][4][2], const Unit& u, int wr, int wc, int fr, int fq) const {
        const int row0 = u.pm * BM + wr * 64 + fr;
        bf16_t* base; int ld, colt;
        if (u.pn < 2) { base = ZA; ld = 512; colt = u.pn * BM; } else { base = ZM; ld = 2048; colt = (u.pn - 2) * BM; }
        const int col0 = colt + wc * 32 + 8 * fq;
#pragma unroll
        for (int ai = 0; ai < 2; ++ai)
#pragma unroll
            for (int m = 0; m < 4; ++m) { const int row = row0 + ai * HALF + m * 16; bf16_t* rowp = base + (size_t)row * ld + col0;
#pragma unroll
                for (int bj = 0; bj < 2; ++bj) *(u32x4*)(rowp + bj * HALF) = pack8(acc[ai][bj][m][0], acc[ai][bj][m][1]);
                if (u.pn == 1) { float* fp = ZAF + (size_t)row * 128 + wc * 32 + 8 * fq; *(f32x4*)fp = acc[ai][1][m][0]; *(f32x4*)(fp + 4) = acc[ai][1][m][1]; } }
    }
};
struct EpiQ {
    static constexpr bool PERM = true, AFTER_DRAIN = false;
    bf16_t* Q; const float* rc; const float* rs; float scale;
    __device__ __forceinline__ void operator()(const f32x4 (&acc)[2][2][4][2], const Unit& u, int wr, int wc, int fr, int fq) const {
        const int row0 = u.pm * BM + wr * 64 + fr;
#pragma unroll
        for (int bj = 0; bj < 2; ++bj) {
            const int c8 = u.pn * BM + bj * HALF + wc * 32 + 8 * fq, h = c8 / QKD, j = c8 - h * QKD;
#pragma unroll
            for (int ai = 0; ai < 2; ++ai)
#pragma unroll
                for (int m = 0; m < 4; ++m) { const int row = row0 + ai * HALF + m * 16, b = row >> 13, s = row & (SEQ - 1);
                    f32x4 v0 = acc[ai][bj][m][0], v1 = acc[ai][bj][m][1];
                    if (j >= 128) { const int i0 = (j - 128) >> 1; const f32x4 c = *(const f32x4*)(rc + (size_t)row * 32 + i0), sn = *(const f32x4*)(rs + (size_t)row * 32 + i0);
                        const f32x4 w0 = v0, w1 = v1;
                        v0[0] = w0[0] * c[0] - w0[1] * sn[0]; v0[1] = w0[1] * c[0] + w0[0] * sn[0]; v0[2] = w0[2] * c[1] - w0[3] * sn[1]; v0[3] = w0[3] * c[1] + w0[2] * sn[1];
                        v1[0] = w1[0] * c[2] - w1[1] * sn[2]; v1[1] = w1[1] * c[2] + w1[0] * sn[2]; v1[2] = w1[2] * c[3] - w1[3] * sn[3]; v1[3] = w1[3] * c[3] + w1[2] * sn[3]; }
                    v0 = v0 * scale; v1 = v1 * scale;
                    *(u32x4*)(Q + ((size_t)(b * NHD + h) * SEQ + s) * QKD + j) = pack8(v0, v1);
                    if (m & 1) asm volatile("" ::: "memory"); }
        }
    }
};
struct EpiKV {
    static constexpr bool PERM = true, AFTER_DRAIN = false;
    bf16_t* K; bf16_t* V;
    __device__ __forceinline__ void operator()(const f32x4 (&acc)[2][2][4][2], const Unit& u, int wr, int wc, int fr, int fq) const {
        const int row0 = u.pm * BM + wr * 64 + fr, h = u.pn, j = wc * 32 + 8 * fq;
#pragma unroll
        for (int ai = 0; ai < 2; ++ai)
#pragma unroll
            for (int m = 0; m < 4; ++m) { const int row = row0 + ai * HALF + m * 16, b = row >> 13, s = row & (SEQ - 1); const size_t tok = (size_t)(b * NHD + h) * SEQ + s;
                *(u32x4*)(K + tok * QKD + j) = pack8(acc[ai][0][m][0], acc[ai][0][m][1]);
                *(u32x4*)(V + tok * VDIM + j) = pack8(acc[ai][1][m][0], acc[ai][1][m][1]); }
    }
};
struct EpiGU {
    static constexpr bool PERM = true, AFTER_DRAIN = false;
    bf16_t* O;
    __device__ __forceinline__ void operator()(const f32x4 (&acc)[2][2][4][2], const Unit& u, int wr, int wc, int fr, int fq) const {
        const int row0 = u.pm * BM + wr * 64 + fr, col0 = u.pn * HALF + wc * 32 + 8 * fq;
#pragma unroll
        for (int ai = 0; ai < 2; ++ai)
#pragma unroll
            for (int m = 0; m < 4; ++m) { f32x4 r0, r1;
#pragma unroll
                for (int e = 0; e < 4; ++e) { const float g0 = acc[ai][0][m][0][e], g1 = acc[ai][0][m][1][e];
                    r0[e] = g0 * sigmoid_f(g0) * acc[ai][1][m][0][e]; r1[e] = g1 * sigmoid_f(g1) * acc[ai][1][m][1][e]; }
                *(u32x4*)(O + (size_t)(row0 + ai * HALF + m * 16) * DFF + col0) = pack8(r0, r1); }
    }
};
struct EpiFin {
    static constexpr bool PERM = true, AFTER_DRAIN = false;
    float* out; const bf16_t* PP;
    __device__ __forceinline__ void operator()(const f32x4 (&acc)[2][2][4][2], const Unit& u, int wr, int wc, int fr, int fq) const {
        const int row0 = u.pm * BM + wr * 64 + fr, col0 = u.pn * BM + wc * 32 + 8 * fq;
#pragma unroll
        for (int ai = 0; ai < 2; ++ai)
#pragma unroll
            for (int m = 0; m < 4; ++m)
#pragma unroll
                for (int bj = 0; bj < 2; ++bj) { const size_t off = (size_t)(row0 + ai * HALF + m * 16) * DM + col0 + bj * HALF;
                    const f32x4 h0 = *(const f32x4*)(out + off), h1 = *(const f32x4*)(out + off + 4); const u32x4 pp = *(const u32x4*)(PP + off);
                    const f32x4 a0 = acc[ai][bj][m][0], a1 = acc[ai][bj][m][1]; f32x4 o0, o1;
                    o0[0] = h0[0] + sigmoid_f(a0[0]) * bf_lo(pp.x); o0[1] = h0[1] + sigmoid_f(a0[1]) * bf_hi(pp.x); o0[2] = h0[2] + sigmoid_f(a0[2]) * bf_lo(pp.y); o0[3] = h0[3] + sigmoid_f(a0[3]) * bf_hi(pp.y);
                    o1[0] = h1[0] + sigmoid_f(a1[0]) * bf_lo(pp.z); o1[1] = h1[1] + sigmoid_f(a1[1]) * bf_hi(pp.z); o1[2] = h1[2] + sigmoid_f(a1[2]) * bf_lo(pp.w); o1[3] = h1[3] + sigmoid_f(a1[3]) * bf_hi(pp.w);
                    *(f32x4*)(out + off) = o0; *(f32x4*)(out + off + 4) = o1;
                    if (bj) asm volatile("" ::: "memory"); }
    }
};

template <class Epi, class Sched, bool ALIGN_EPI = false, bool SP2 = false>
__device__ __forceinline__ void gemm_phase(PG8_LAS unsigned char* lds, const Gemm g, const Sched& S, const Epi& E) {
    const int tid = threadIdx.x, wid = __builtin_amdgcn_readfirstlane(tid >> 6), lane = tid & 63, wr = wid >> 2, wc = wid & 3, fr = lane & 15, fq = lane >> 4;
    int K = g.K; asm volatile("" : "+s"(K)); const int nt = K / BK;
    unsigned voffA[2], voffB[2];
#pragma unroll
    for (int i = 0; i < 2; ++i) { int R, C; stage_rc(tid * 16 + i * 8192, R, C); const int Rb = Epi::PERM ? ((R & ~31) + perm32(R & 31)) : R;
        voffA[i] = (unsigned)(R * g.lda + C) * 2u; voffB[i] = (unsigned)(Rb * K + C) * 2u; }
    const size_t kstep = (size_t)(BK * 2);
    const size_t hstepA = (size_t)HALF * g.lda * 2, hstepB = (size_t)HALF * K * 2;
    const size_t tstepA = 2 * hstepA, tstepB = 2 * hstepB;
    const unsigned ldsw = (unsigned)wid * 1024u;
    const int aoff = lds_byte(wr * 64 + fr, fq * 8), boff = lds_byte(wc * 32 + fr, fq * 8);
#define PG8_SA(b, h) (((b) * 2 + (h)) * HTB)
#define PG8_SB(b, h) ((4 + (b) * 2 + (h)) * HTB)
#define PG8_STAGE(bufoff, gbase, voff) do { _Pragma("unroll") for (int _i = 0; _i < 2; ++_i) \
        __builtin_amdgcn_global_load_lds((const unsigned*)((const char*)(gbase) + (voff)[_i]), (PG8_LAS unsigned*)(lds + (bufoff) + ldsw + _i * 8192), 16, 0, 0); } while (0)
#define PG8_LDA(dst, b, h) do { _Pragma("unroll") for (int m = 0; m < 4; ++m) _Pragma("unroll") for (int k = 0; k < 2; ++k) dst[m][k] = *(const PG8_LAS bf16x8*)(lds + PG8_SA(b, h) + aoff + m * 2048 + k * 1024); } while (0)
#define PG8_LDB(dst, b, h) do { _Pragma("unroll") for (int n = 0; n < 2; ++n) _Pragma("unroll") for (int k = 0; k < 2; ++k) dst[n][k] = *(const PG8_LAS bf16x8*)(lds + PG8_SB(b, h) + boff + n * 2048 + k * 1024); } while (0)
#define PG8_MMA(ai, bj, At, Bt) do { __builtin_amdgcn_s_setprio(1); _Pragma("unroll") for (int m = 0; m < 4; ++m) _Pragma("unroll") for (int n = 0; n < 2; ++n) _Pragma("unroll") for (int k = 0; k < 2; ++k) \
        acc[ai][bj][m][n] = __builtin_amdgcn_mfma_f32_16x16x32_bf16(Bt[n][k], At[m][k], acc[ai][bj][m][n], 0, 0, 0); __builtin_amdgcn_s_setprio(0); } while (0)
#define PG8_WAIT_V(n) asm volatile("s_waitcnt vmcnt(" #n ")" ::: "memory")
#define PG8_WAIT_L(n) asm volatile("s_waitcnt lgkmcnt(" #n ")" ::: "memory")
#define PG8_BAR __builtin_amdgcn_s_barrier()
#define PG8_SCHED __builtin_amdgcn_sched_barrier(0)
    Unit cur, nxt; int ui = 0;
    if (!S.next(0, cur)) return;
    f32x4 acc[2][2][4][2];
#pragma unroll
    for (int a = 0; a < 2; ++a)
#pragma unroll
        for (int b = 0; b < 2; ++b)
#pragma unroll
            for (int m = 0; m < 4; ++m)
#pragma unroll
                for (int n = 0; n < 2; ++n) acc[a][b][m][n] = (f32x4){0.f, 0.f, 0.f, 0.f};
    bf16x8 At[4][2], B0[2][2], B1[2][2];
    const char* cA = (const char*)g.A + (size_t)cur.pm * tstepA; const char* cB = (const char*)g.Bt + (size_t)cur.pn * tstepB;
    S.a_ready(cur);
    if constexpr (SP2) {
        PG8_STAGE(PG8_SB(0, 0), cB, voffB); PG8_STAGE(PG8_SB(0, 1), cB + hstepB, voffB); PG8_STAGE(PG8_SA(0, 0), cA, voffA); PG8_STAGE(PG8_SA(0, 1), cA + hstepA, voffA);
        if (wr == 1) PG8_BAR;
        PG8_WAIT_V(2); PG8_BAR;
        PG8_STAGE(PG8_SB(1, 0), cB + kstep, voffB); PG8_STAGE(PG8_SA(1, 0), cA + kstep, voffA); PG8_STAGE(PG8_SB(1, 1), cB + hstepB + kstep, voffB);
        PG8_WAIT_V(6); PG8_BAR;
    } else {
        PG8_STAGE(PG8_SB(0, 0), cB, voffB); PG8_STAGE(PG8_SA(0, 0), cA, voffA); PG8_STAGE(PG8_SB(0, 1), cB + hstepB, voffB); PG8_STAGE(PG8_SA(0, 1), cA + hstepA, voffA);
        if (wr == 1) PG8_BAR;
        PG8_WAIT_V(4); PG8_BAR;
        PG8_STAGE(PG8_SB(1, 0), cB + kstep, voffB); PG8_STAGE(PG8_SA(1, 0), cA + kstep, voffA); PG8_STAGE(PG8_SB(1, 1), cB + hstepB + kstep, voffB);
        PG8_WAIT_V(6); PG8_BAR;
    }
    for (;;) {
        const bool has_next = S.next(ui + 1, nxt);
        const char* nA = has_next ? (const char*)g.A + (size_t)nxt.pm * tstepA : cA; const char* nB = has_next ? (const char*)g.Bt + (size_t)nxt.pn * tstepB : cB;
        for (int t = 0; t < nt; t += 2) {
            const bool last = (t == nt - 2);
            const char* a1 = cA + (size_t)(t + 1) * kstep;
            const char* a2 = last ? nA : cA + (size_t)(t + 2) * kstep; const char* b2 = last ? nB : cB + (size_t)(t + 2) * kstep;
            const char* a3 = a2 + kstep; const char* b3 = b2 + kstep;
            if (last && has_next) S.a_ready(nxt);
            if constexpr (SP2) {
            PG8_LDB(B0, 0, 0); PG8_LDB(B1, 0, 1); PG8_SCHED; PG8_LDA(At, 0, 0); PG8_STAGE(PG8_SA(1, 1), a1 + hstepA, voffA);
            PG8_WAIT_V(8); PG8_WAIT_L(0); PG8_BAR; PG8_MMA(0, 0, At, B0); PG8_MMA(0, 1, At, B1); PG8_BAR; PG8_SCHED;
            PG8_LDA(At, 0, 1); PG8_STAGE(PG8_SB(0, 0), b2, voffB); PG8_STAGE(PG8_SB(0, 1), b2 + hstepB, voffB); PG8_STAGE(PG8_SA(0, 0), a2, voffA);
            PG8_WAIT_V(8); PG8_WAIT_L(0); PG8_BAR; PG8_MMA(1, 0, At, B0); PG8_MMA(1, 1, At, B1); PG8_BAR; PG8_SCHED;
            PG8_LDB(B0, 1, 0); PG8_LDB(B1, 1, 1); PG8_SCHED; PG8_LDA(At, 1, 0); PG8_STAGE(PG8_SA(0, 1), a2 + hstepA, voffA);
            PG8_WAIT_V(8); PG8_WAIT_L(0); PG8_BAR; PG8_MMA(0, 0, At, B0); PG8_MMA(0, 1, At, B1); PG8_BAR; PG8_SCHED;
            PG8_LDA(At, 1, 1); PG8_STAGE(PG8_SB(1, 0), b3, voffB); PG8_STAGE(PG8_SB(1, 1), b3 + hstepB, voffB); PG8_STAGE(PG8_SA(1, 0), a3, voffA);
            PG8_WAIT_V(8); PG8_WAIT_L(0); PG8_BAR; PG8_MMA(1, 0, At, B0); PG8_MMA(1, 1, At, B1); PG8_BAR; PG8_SCHED;
            } else {
            PG8_LDB(B0, 0, 0); PG8_SCHED; PG8_LDA(At, 0, 0); PG8_STAGE(PG8_SA(1, 1), a1 + hstepA, voffA);
            PG8_WAIT_L(8); PG8_BAR; PG8_WAIT_L(0); PG8_MMA(0, 0, At, B0); PG8_BAR; PG8_SCHED;
            PG8_LDB(B1, 0, 1); PG8_STAGE(PG8_SB(0, 0), b2, voffB);
            PG8_BAR; PG8_WAIT_L(0); PG8_MMA(0, 1, At, B1); PG8_BAR;
            PG8_LDA(At, 0, 1); PG8_STAGE(PG8_SA(0, 0), a2, voffA);
            PG8_BAR; PG8_WAIT_L(0); PG8_MMA(1, 0, At, B0); PG8_BAR; PG8_SCHED;
            PG8_STAGE(PG8_SB(0, 1), b2 + hstepB, voffB);
            PG8_WAIT_V(6); PG8_BAR; PG8_MMA(1, 1, At, B1); PG8_BAR;
            PG8_LDB(B0, 1, 0); PG8_SCHED; PG8_LDA(At, 1, 0); PG8_STAGE(PG8_SA(0, 1), a2 + hstepA, voffA);
            PG8_WAIT_L(8); PG8_BAR; PG8_WAIT_L(0); PG8_MMA(0, 0, At, B0); PG8_BAR; PG8_SCHED;
            PG8_LDB(B1, 1, 1); PG8_STAGE(PG8_SB(1, 0), b3, voffB);
            PG8_BAR; PG8_WAIT_L(0); PG8_MMA(0, 1, At, B1); PG8_BAR;
            PG8_LDA(At, 1, 1); PG8_STAGE(PG8_SA(1, 0), a3, voffA);
            PG8_BAR; PG8_WAIT_L(0); PG8_MMA(1, 0, At, B0); PG8_BAR; PG8_SCHED;
            PG8_STAGE(PG8_SB(1, 1), b3 + hstepB, voffB);
            PG8_WAIT_V(6); PG8_BAR; PG8_MMA(1, 1, At, B1); PG8_BAR;
            }
        }
        if constexpr (ALIGN_EPI) { if (wr == 0) PG8_BAR; }
        if constexpr (!Epi::AFTER_DRAIN) { E(acc, cur, wr, wc, fr, fq); S.done(cur); }
        if (!has_next) break;
#pragma unroll
        for (int a = 0; a < 2; ++a)
#pragma unroll
            for (int b = 0; b < 2; ++b)
#pragma unroll
                for (int m = 0; m < 4; ++m)
#pragma unroll
                    for (int n = 0; n < 2; ++n) acc[a][b][m][n] = (f32x4){0.f, 0.f, 0.f, 0.f};
        cur = nxt; cA = nA; cB = nB; ++ui;
        if constexpr (ALIGN_EPI) { if (wr == 1) PG8_BAR; }
    }
    PG8_WAIT_V(0);
    if constexpr (!ALIGN_EPI) { if (wr == 0) PG8_BAR; }
    PG8_BAR;
    if constexpr (Epi::AFTER_DRAIN) { E.fused(acc, cur, wr, wc, fr, fq, lds, wid, lane); S.done(cur); }
#undef PG8_SA
#undef PG8_SB
#undef PG8_STAGE
#undef PG8_LDA
#undef PG8_LDB
#undef PG8_MMA
#undef PG8_WAIT_V
#undef PG8_WAIT_L
#undef PG8_BAR
#undef PG8_SCHED
}
}

#define LAS __attribute__((address_space(3)))
#define GAS __attribute__((address_space(1)))
namespace mk {
typedef unsigned short bf16_t;
typedef short bf16x8 __attribute__((ext_vector_type(8)));
typedef short s16x4 __attribute__((ext_vector_type(4)));
typedef float f32x16 __attribute__((ext_vector_type(16)));
typedef float f32x4 __attribute__((ext_vector_type(4)));
typedef unsigned u32x4 __attribute__((ext_vector_type(4)));
typedef unsigned u32x2 __attribute__((ext_vector_type(2)));
typedef const LAS unsigned char* lds_cptr;
typedef LAS unsigned char* lds_ptr;
#define SBAR() __builtin_amdgcn_sched_barrier(0)
#define LGKM0() asm volatile("s_waitcnt lgkmcnt(0)" ::: "memory")
#define VMCNT0() asm volatile("s_waitcnt vmcnt(0)" ::: "memory")
#define WG_BARRIER() do { asm volatile("s_waitcnt vmcnt(0) lgkmcnt(0)" ::: "memory"); __builtin_amdgcn_s_barrier(); asm volatile("" ::: "memory"); } while (0)

__device__ __forceinline__ int crow(int r, int hi) { return (r & 3) + 8 * (r >> 2) + 4 * hi; }
__device__ __forceinline__ unsigned cvtpk(float lo, float hi) { unsigned r; asm volatile("v_cvt_pk_bf16_f32 %0, %1, %2" : "=v"(r) : "v"(lo), "v"(hi)); return r; }
__device__ __forceinline__ float sigmoid_f(float x) { return __builtin_amdgcn_rcpf(1.f + __builtin_amdgcn_exp2f(-x * 1.4426950408889634f)); }
__device__ __forceinline__ float bflo(unsigned w) { return __uint_as_float(w << 16); }
__device__ __forceinline__ float bfhi(unsigned w) { return __uint_as_float(w & 0xffff0000u); }
__device__ __forceinline__ u32x4 pack8f(const float* v) { u32x4 w; w.x = cvtpk(v[0], v[1]); w.y = cvtpk(v[2], v[3]); w.z = cvtpk(v[4], v[5]); w.w = cvtpk(v[6], v[7]); return w; }
__device__ __forceinline__ void unpack8(u32x4 w, float* v) { v[0] = bflo(w.x); v[1] = bfhi(w.x); v[2] = bflo(w.y); v[3] = bfhi(w.y); v[4] = bflo(w.z); v[5] = bfhi(w.z); v[6] = bflo(w.w); v[7] = bfhi(w.w); }
__device__ __forceinline__ int v_st(int k, int c) { const int kk = (k & ~0xC) | ((k & 4) << 1) | ((k & 8) >> 1); return ((kk >> 3) * 4 + (c >> 5)) * 512 + ((kk & 7) * 32 + (c & 31)) * 2; }
__device__ __forceinline__ int v_rd_base(int lane) { return ((lane & 3) << 3) | (((lane >> 2) & 3) << 6) | (((lane >> 4) & 1) << 5) | (((lane >> 5) & 1) << 8); }
typedef short v4i16_t __attribute__((ext_vector_type(4)));
__device__ __forceinline__ s16x4 vtr(lds_cptr p) { return __builtin_bit_cast(s16x4, __builtin_amdgcn_ds_read_tr16_b64_v4i16((LAS v4i16_t*)p)); }
__device__ __forceinline__ bf16x8 frag_tr(lds_cptr p) { const s16x4 lo = vtr(p), hh = vtr(p + 2048); return (bf16x8){lo[0], lo[1], lo[2], lo[3], hh[0], hh[1], hh[2], hh[3]}; }
#define MK_PK4(P, B_, OUT) do { const unsigned a0_ = cvtpk(P[B_ + 0], P[B_ + 1]), a1_ = cvtpk(P[B_ + 2], P[B_ + 3]), b0_ = cvtpk(P[B_ + 4], P[B_ + 5]), b1_ = cvtpk(P[B_ + 6], P[B_ + 7]); \
        const auto r0_ = __builtin_amdgcn_permlane32_swap(a0_, b0_, false, false); const auto r1_ = __builtin_amdgcn_permlane32_swap(a1_, b1_, false, false); \
        const u32x4 w_ = {r0_[0], r1_[0], r0_[1], r1_[1]}; OUT = __builtin_bit_cast(bf16x8, w_); } while (0)
__device__ __forceinline__ float half_swap_add(float v) { const auto rr = __builtin_amdgcn_permlane32_swap(__float_as_uint(v), __float_as_uint(v), false, false); return __uint_as_float(rr[0]) + __uint_as_float(rr[1]); }
__device__ __forceinline__ float half_swap_max(float v) { const auto rr = __builtin_amdgcn_permlane32_swap(__float_as_uint(v), __float_as_uint(v), false, false); return fmaxf(__uint_as_float(rr[0]), __uint_as_float(rr[1])); }
__device__ __forceinline__ void glds16(const void* gsrc, lds_ptr dst) { __builtin_amdgcn_global_load_lds((const unsigned*)gsrc, (LAS unsigned*)dst, 16, 0, 0); }

}
namespace att {
using namespace mk;
constexpr int KT = 24576, VT = 16384, NSL = 3;
constexpr int L_K = 0, L_V = NSL * KT, L_WS = L_V + NSL * VT, L_END = L_WS + 8 * 256;
constexpr float THR2 = 8.f;

__device__ __forceinline__ void mask_tile(f32x16& p0, f32x16& p1, int dq) {
#pragma unroll
    for (int r = 0; r < 16; ++r) { const int c = (r & 3) + 8 * (r >> 2);
        p0[r] = fminf(p0[r], __uint_as_float(0x7f800000u | ((unsigned)(dq - c) & 0x80000000u)));
        p1[r] = fminf(p1[r], __uint_as_float(0x7f800000u | ((unsigned)(dq - c - 32) & 0x80000000u))); }
}
__device__ __forceinline__ void partialSM(f32x16& p0, f32x16& p1, float& m_reg, float& alpha) {
    float pmax = p0[0];
#pragma unroll
    for (int r = 1; r < 16; ++r) pmax = fmaxf(pmax, p0[r]);
#pragma unroll
    for (int r = 0; r < 16; ++r) pmax = fmaxf(pmax, p1[r]);
    pmax = half_swap_max(pmax);
    float mn;
    if (__builtin_expect(__all(pmax - m_reg <= THR2), 1)) { mn = m_reg; alpha = 1.f; }
    else { mn = fmaxf(m_reg, pmax); alpha = __builtin_amdgcn_exp2f(m_reg - mn); m_reg = mn; }
#pragma unroll
    for (int r = 0; r < 16; ++r) { p0[r] -= mn; p1[r] -= mn; }
#pragma unroll
    for (int r = 0; r < 16; ++r) p0[r] = __builtin_amdgcn_exp2f(p0[r]);
}
__device__ __forceinline__ void finishSM(f32x16& p0, f32x16& p1, float alpha, float& l_reg, bf16x8& pa0, bf16x8& pa1, bf16x8& pa2, bf16x8& pa3) {
#pragma unroll
    for (int r = 0; r < 16; ++r) p1[r] = __builtin_amdgcn_exp2f(p1[r]);
    float ps = 0.f;
#pragma unroll
    for (int r = 0; r < 16; ++r) ps += p0[r];
#pragma unroll
    for (int r = 0; r < 16; ++r) ps += p1[r];
    ps = half_swap_add(ps);
    l_reg = l_reg * alpha + ps;
    MK_PK4(p0, 0, pa0); MK_PK4(p0, 8, pa1); MK_PK4(p1, 0, pa2); MK_PK4(p1, 8, pa3);
}
__device__ __forceinline__ void qkt(f32x16& p0, f32x16& p1, lds_cptr ks, const int (&kbo)[4], const bf16x8* qr) {
    p0 = f32x16{}; p1 = f32x16{};
#pragma unroll
    for (int d0 = 0; d0 < 12; ++d0) { lds_cptr a = ks + kbo[d0 & 3] + (d0 >> 2) * 8192;
        const bf16x8 b0 = *(const LAS bf16x8*)a, b1 = *(const LAS bf16x8*)(a + 4096);
        p0 = __builtin_amdgcn_mfma_f32_32x32x16_bf16(b0, qr[d0], p0, 0, 0, 0);
        p1 = __builtin_amdgcn_mfma_f32_32x32x16_bf16(b1, qr[d0], p1, 0, 0, 0); }
}
__device__ __forceinline__ void pv_tile(f32x16* o, lds_cptr vb, bf16x8 pa0, bf16x8 pa1, bf16x8 pa2, bf16x8 pa3) {
#pragma unroll
    for (int d0 = 0; d0 < 4; ++d0) {
        const bf16x8 f0 = frag_tr(vb + d0 * 512), f1 = frag_tr(vb + d0 * 512 + 4096), f2 = frag_tr(vb + d0 * 512 + 8192), f3 = frag_tr(vb + d0 * 512 + 12288);
        o[d0] = __builtin_amdgcn_mfma_f32_32x32x16_bf16(pa0, f0, o[d0], 0, 0, 0);
        o[d0] = __builtin_amdgcn_mfma_f32_32x32x16_bf16(pa1, f1, o[d0], 0, 0, 0);
        o[d0] = __builtin_amdgcn_mfma_f32_32x32x16_bf16(pa2, f2, o[d0], 0, 0, 0);
        o[d0] = __builtin_amdgcn_mfma_f32_32x32x16_bf16(pa3, f3, o[d0], 0, 0, 0); }
}
__device__ __forceinline__ void attn_unit(int b, int h, int qb, const bf16_t* Qb, const bf16_t* Kb, const bf16_t* Vb, bf16_t* MIX, lds_ptr lds) {
    const int tid = threadIdx.x, wid = __builtin_amdgcn_readfirstlane(tid >> 6), lane = tid & 63, r32 = lane & 31, hi = lane >> 5;
    const size_t bh = (size_t)(b * NHD + h);
    const bf16_t* Qw = Qb + (bh * SEQ + (size_t)qb * 256 + wid * 32 + r32) * QKD;
    const bf16_t* Kh = Kb + bh * SEQ * QKD; const bf16_t* Vh = Vb + bh * SEQ * VDIM;
    const int NT = (qb + 1) * 4;
    const bf16_t* ksrc; const bf16_t* vsrc[2];
    { const int r = 8 * wid + (lane >> 3), c = (lane & 7) ^ ((r >> 1) & 7); ksrc = Kh + (size_t)r * QKD + c * 8; }
#pragma unroll
    for (int i = 0; i < 2; ++i) { const int p = wid + 8 * i, st = 2 * p + (lane >> 5), kk = (st >> 2) * 8 + ((lane & 31) >> 2), k = (kk & ~0xC) | ((kk & 4) << 1) | ((kk & 8) >> 1), c = (st & 3) * 32 + (lane & 3) * 8;
        vsrc[i] = Vh + (size_t)k * VDIM + c; }
#define ATT_DMA(t, slot) do { _Pragma("unroll") for (int i_ = 0; i_ < 3; ++i_) glds16(ksrc + (size_t)(t) * 64 * QKD + i_ * 64, lds + L_K + (slot) * KT + i_ * 8192 + wid * 1024); \
        _Pragma("unroll") for (int i_ = 0; i_ < 2; ++i_) glds16(vsrc[i_] + (size_t)(t) * 64 * VDIM, lds + L_V + (slot) * VT + (wid + 8 * i_) * 1024); } while (0)
    int kbo[4];
#pragma unroll
    for (int dd = 0; dd < 4; ++dd) kbo[dd] = r32 * 128 + (((dd * 2 + hi) ^ ((r32 >> 1) & 7)) * 16);
    const int vrb = v_rd_base(lane);
    LAS float* ws = (LAS float*)(lds + L_WS) + wid * 64; LAS float* li_l = ws; LAS float* al_l = ws + 32;
    ATT_DMA(0, 0); ATT_DMA(1, 1);
    bf16x8 qr[12];
#pragma unroll
    for (int d0 = 0; d0 < 12; ++d0) qr[d0] = *(const bf16x8*)(Qw + d0 * 16 + hi * 8);
    float m_reg = -1e30f, l_reg = 0.f; f32x16 o[4] = {};
    const int qlo = qb * 256 + wid * 32, qm = qlo + r32 - 4 * hi;
    f32x16 pA0, pA1, pB0, pB1; float alA, alB; bf16x8 pa0, pa1, pa2, pa3;
    WG_BARRIER();
    int s_prev = 0, s_cur = 0, s_next = 1;
#define ATT_ROT() do { s_prev = s_cur; s_cur = s_next; s_next = (s_next == NSL - 1) ? 0 : s_next + 1; } while (0)
#define ATT_RESC(a) do { if (__any((a) < 1.f)) { if (hi == 0) al_l[r32] = (a); LGKM0(); \
        _Pragma("unroll") for (int d_ = 0; d_ < 4; ++d_) _Pragma("unroll") for (int r = 0; r < 16; ++r) o[d_][r] *= al_l[crow(r, hi)]; } } while (0)
#define ATT_MASK(P0_, P1_, t) do { const int kb_ = (t) * 64; if (kb_ + 63 > qlo) mask_tile(P0_, P1_, qm - kb_); } while (0)
    qkt(pA0, pA1, lds + L_K, kbo, qr); ATT_MASK(pA0, pA1, 0); partialSM(pA0, pA1, m_reg, alA);
    WG_BARRIER();
    ATT_RESC(alA); ATT_ROT();
#define ATT_STEP(PX0, PX1, alX, PY0, PY1, alY, t) do { \
        if ((t) + 1 < NT) ATT_DMA((t) + 1, s_next); \
        SBAR(); qkt(PX0, PX1, lds + L_K + s_cur * KT, kbo, qr); \
        finishSM(PY0, PY1, alY, l_reg, pa0, pa1, pa2, pa3); SBAR(); \
        pv_tile(o, lds + L_V + s_prev * VT + vrb, pa0, pa1, pa2, pa3); \
        ATT_MASK(PX0, PX1, (t)); partialSM(PX0, PX1, m_reg, alX); \
        WG_BARRIER(); ATT_RESC(alX); ATT_ROT(); } while (0)
    int t = 1;
    for (; t + 1 < NT; t += 2) {
        ATT_STEP(pB0, pB1, alB, pA0, pA1, alA, t);
        ATT_STEP(pA0, pA1, alA, pB0, pB1, alB, t + 1);
    }
    ATT_STEP(pB0, pB1, alB, pA0, pA1, alA, NT - 1);
    finishSM(pB0, pB1, alB, l_reg, pa0, pa1, pa2, pa3); SBAR();
    pv_tile(o, lds + L_V + s_prev * VT + vrb, pa0, pa1, pa2, pa3);
    if (hi == 0) li_l[r32] = l_reg; LGKM0();
    float rli[16];
#pragma unroll
    for (int r = 0; r < 16; ++r) rli[r] = __builtin_amdgcn_rcpf(li_l[crow(r, hi)]);
    bf16_t* Ow = MIX + ((size_t)b * SEQ + (size_t)qb * 256 + wid * 32) * DM + h * VDIM;
#pragma unroll
    for (int r = 0; r < 16; ++r) { const int orow = crow(r, hi);
#pragma unroll
        for (int d0 = 0; d0 < 4; ++d0) { const float v = o[d0][r] * rli[r]; const float vn = __shfl_xor(v, 1);
            if ((r32 & 1) == 0) *(unsigned*)(Ow + (size_t)orow * DM + d0 * 32 + r32) = cvtpk(v, vn); } }
    WG_BARRIER();
#undef ATT_DMA
#undef ATT_ROT
#undef ATT_RESC
#undef ATT_MASK
#undef ATT_STEP
}
}

namespace ml {
using namespace mk;
constexpr int L_KI = 0, L_VI = 65536;
#define KSWZ(row, colB) ((row) * 256 + ((colB) ^ (((row) & 7) << 4)))
__device__ __forceinline__ float incl_scan_sum(float v, int lane) {
#pragma unroll
    for (int o = 1; o < 64; o <<= 1) { const float t = __shfl_up(v, o); if (lane >= o) v += t; }
    return v;
}
__device__ __forceinline__ float incl_scan_max(float v, int lane) {
#pragma unroll
    for (int o = 1; o < 64; o <<= 1) { const float t = __shfl_up(v, o); if (lane >= o) v = fmaxf(v, t); }
    return v;
}
__device__ __forceinline__ float wave_max(float v) {
#pragma unroll
    for (int o = 1; o < 64; o <<= 1) v = fmaxf(v, __shfl_xor(v, o));
    return v;
}
struct Tens {
    const bf16_t* ZM; const float* GATE; const float* conv_w; const float* conv_b; const float* gnorm;
    bf16_t* MQ; bf16_t* MK; bf16_t* DC; float* DN; float* NS; float* GG; float* ML; float* MS; bf16_t* MIX;
};
__device__ __forceinline__ void pass_a(const Tens& T, int item, lds_ptr lds, lds_ptr misc) {
    const int tid = threadIdx.x, wid = __builtin_amdgcn_readfirstlane(tid >> 6), lane = tid & 63, r32 = lane & 31, hi = lane >> 5;
    const int b = item >> 7, c = item & 127; const size_t row0 = (size_t)b * SEQ + (size_t)c * 64;
    LAS float* WT = (LAS float*)misc; LAS float* PS = (LAS float*)(misc + 1024);
    { const int h = wid >> 1; const float iv = T.GATE[(row0 + lane) * 8 + h], lf = T.GATE[(row0 + lane) * 8 + 4 + h];
      const float bs = incl_scan_sum(lf, lane); const float g = __shfl(bs, 63); const float a = g - bs + iv; const float mloc = wave_max(a); const float w = __expf(a - mloc);
      if ((wid & 1) == 0) { WT[h * 64 + lane] = w; if (lane == 0) { T.GG[item * 4 + h] = g; T.ML[item * 4 + h] = mloc; } } }
    WG_BARRIER();
    {
      const int cg = tid & 127, rg = tid >> 7, ch = cg * 8, r0 = rg * 16; const bool isk = cg >= 64; const int head = (ch & 511) >> 7;
      float cw[4][8], cb[8];
#pragma unroll
      for (int j = 0; j < 4; ++j) { const f32x4 a = *(const f32x4*)(T.conv_w + j * 1024 + ch), bq = *(const f32x4*)(T.conv_w + j * 1024 + ch + 4);
#pragma unroll
          for (int e = 0; e < 4; ++e) { cw[j][e] = a[e]; cw[j][4 + e] = bq[e]; } }
      { const f32x4 a = *(const f32x4*)(T.conv_b + ch), bq = *(const f32x4*)(T.conv_b + ch + 4);
#pragma unroll
        for (int e = 0; e < 4; ++e) { cb[e] = a[e]; cb[4 + e] = bq[e]; } }
      float x0[8], x1[8], x2[8], x3[8], psum[8];
#pragma unroll
      for (int e = 0; e < 8; ++e) psum[e] = 0.f;
      const int s0 = c * 64 + r0;
      { u32x4 z = {0u, 0u, 0u, 0u};
        const u32x4 a0 = (s0 - 3 >= 0) ? *(const u32x4*)(T.ZM + (row0 + r0 - 3) * 2048 + ch) : z; unpack8(a0, x0);
        const u32x4 a1 = (s0 - 2 >= 0) ? *(const u32x4*)(T.ZM + (row0 + r0 - 2) * 2048 + ch) : z; unpack8(a1, x1);
        const u32x4 a2 = (s0 - 1 >= 0) ? *(const u32x4*)(T.ZM + (row0 + r0 - 1) * 2048 + ch) : z; unpack8(a2, x2); }
#pragma unroll 4
      for (int r = 0; r < 16; ++r) {
          const u32x4 a3 = *(const u32x4*)(T.ZM + (row0 + r0 + r) * 2048 + ch); unpack8(a3, x3);
          float y[8];
#pragma unroll
          for (int e = 0; e < 8; ++e) { const float v = cb[e] + cw[0][e] * x0[e] + cw[1][e] * x1[e] + cw[2][e] * x2[e] + cw[3][e] * x3[e]; y[e] = v * sigmoid_f(v); x0[e] = x1[e]; x1[e] = x2[e]; x2[e] = x3[e]; }
          if (!isk) { *(u32x4*)(T.MQ + (row0 + r0 + r) * MLW + ch) = pack8f(y); }
          else { const float w = WT[head * 64 + r0 + r];
#pragma unroll
              for (int e = 0; e < 8; ++e) y[e] *= KSCALE_ML;
              *(u32x4*)(T.MK + (row0 + r0 + r) * MLW + (ch - 512)) = pack8f(y);
#pragma unroll
              for (int e = 0; e < 8; ++e) { y[e] *= w; psum[e] += y[e]; }
              *(LAS u32x4*)(lds + L_KI + head * 16384 + v_st(r0 + r, (ch - 512) & 127)) = pack8f(y); }
      }
      if (isk) {
#pragma unroll
          for (int e = 0; e < 8; ++e) PS[rg * 512 + (ch - 512) + e] = psum[e]; }
    }
    {
      const int cgv = tid & 63, rb = tid >> 6, head = cgv >> 4;
#pragma unroll
      for (int i = 0; i < 8; ++i) { const int r = rb + 8 * i;
          *(LAS u32x4*)(lds + L_VI + head * 16384 + v_st(r, (cgv & 15) * 8)) = *(const u32x4*)(T.ZM + (row0 + r) * 2048 + 1024 + cgv * 8); }
    }
    WG_BARRIER();
    { const int chn = tid; T.DN[((size_t)item * 4 + (chn >> 7)) * 128 + (chn & 127)] = (PS[chn] + PS[512 + chn]) + (PS[1024 + chn] + PS[1536 + chn]); }
    { const int h = wid >> 1, half = wid & 1; const int vrb = v_rd_base(lane);
      lds_cptr vi = lds + L_VI + h * 16384 + vrb; lds_cptr ki = lds + L_KI + h * 16384 + vrb;
      bf16_t* dc = T.DC + ((size_t)item * 4 + h) * 16384;
#pragma unroll
      for (int vbi = 0; vbi < 2; ++vbi) { const int vb = 2 * half + vbi; f32x16 acc[4] = {};
#pragma unroll
          for (int ks = 0; ks < 4; ++ks) { const bf16x8 af = frag_tr(vi + vb * 512 + ks * 4096);
#pragma unroll
              for (int db = 0; db < 4; ++db) { const bf16x8 bfr = frag_tr(ki + db * 512 + ks * 4096); acc[db] = __builtin_amdgcn_mfma_f32_32x32x16_bf16(af, bfr, acc[db], 0, 0, 0); } }
#pragma unroll
          for (int db = 0; db < 4; ++db)
#pragma unroll
              for (int r = 0; r < 16; ++r) { const float v = acc[db][r]; const float vn = __shfl_xor(v, 1);
                  if ((r32 & 1) == 0) *(unsigned*)(dc + (size_t)(vb * 32 + crow(r, hi)) * 128 + db * 32 + r32) = cvtpk(v, vn); } }
    }
    WG_BARRIER();
}
__device__ __forceinline__ void pass_b(const Tens& T, int v, lds_ptr misc) {
    const int tid = threadIdx.x; const int bh = v >> 4, slice = v & 15, b = bh >> 2, h = bh & 3;
    LAS float* tg = (LAS float*)misc; LAS float* tm = tg + 128; LAS float* dec = tg + 256; LAS float* scl = tg + 384;
    if (tid < 128) { const size_t ix = ((size_t)b * NCH + tid) * 4 + h; tg[tid] = T.GG[ix]; tm[tid] = T.ML[ix]; }
    WG_BARRIER();
    if (tid == 0) { float m = 0.f;
        for (int c = 0; c < NCH; ++c) { const float g = tg[c], mloc = tm[c]; const float m1 = fmaxf(g + m, mloc); dec[c] = __expf(g + m - m1); scl[c] = __expf(mloc - m1);
            if (slice == 0) T.MS[((size_t)b * NCH + c) * 4 + h] = m; m = m1; } }
    WG_BARRIER();
    if (slice == 0 && tid < 128) { float n = 0.f;
        for (int c = 0; c < NCH; ++c) { const size_t ix = (((size_t)b * NCH + c) * 4 + h) * 128 + tid; T.NS[ix] = n; n = dec[c] * n + scl[c] * T.DN[ix]; } }
    { const int e = slice * 1024 + tid * 2; float c0 = 0.f, c1 = 0.f;
      unsigned* base = (unsigned*)(T.DC + ((size_t)b * NCH * 4 + h) * 16384 + e);
      for (int cc = 0; cc < NCH; cc += 8) { unsigned x[8];
#pragma unroll
          for (int i = 0; i < 8; ++i) x[i] = __builtin_nontemporal_load(base + (size_t)(cc + i) * (4 * 16384 / 2));
#pragma unroll
          for (int i = 0; i < 8; ++i) { base[(size_t)(cc + i) * (4 * 16384 / 2)] = cvtpk(c0, c1); const float d = dec[cc + i], s = scl[cc + i]; c0 = d * c0 + s * bflo(x[i]); c1 = d * c1 + s * bfhi(x[i]); } }
    }
    WG_BARRIER();
}
__device__ __forceinline__ void pass_c(const Tens& T, int item, lds_ptr lds, lds_ptr misc) {
    const int tid = threadIdx.x, wid = __builtin_amdgcn_readfirstlane(tid >> 6), lane = tid & 63, r32 = lane & 31, hi = lane >> 5;
    const int b = item >> 7, c = item & 127; const size_t row0 = (size_t)b * SEQ + (size_t)c * 64;
    const int h = wid >> 1, half = wid & 1, j0 = 32 * half;
    LAS float* TU2 = (LAS float*)(misc + wid * 768); LAS float* TB = TU2 + 64; LAS float* TM = TU2 + 128; LAS float* SC = (LAS float*)(misc + 8 * 768) + wid * 64;
    { const int head = tid >> 7, sr = (tid & 127) >> 4, sc = (tid & 15) * 8;
#pragma unroll
      for (int i = 0; i < 8; ++i) { const int r = sr + 8 * i;
          *(LAS u32x4*)(lds + L_KI + head * 16384 + KSWZ(r, sc * 2)) = *(const u32x4*)(T.MK + (row0 + r) * MLW + head * 128 + sc);
          *(LAS u32x4*)(lds + L_VI + head * 16384 + v_st(r, sc)) = *(const u32x4*)(T.ZM + (row0 + r) * 2048 + 1024 + head * 128 + sc); } }
    const float mcar = T.MS[(size_t)item * 4 + h];
    { const float iv = T.GATE[(row0 + lane) * 8 + h], lf = T.GATE[(row0 + lane) * 8 + 4 + h];
      const float bs = incl_scan_sum(lf, lane); const float u = iv - bs; const float pm = incl_scan_max(u, lane);
      TU2[lane] = u * LOG2E; TB[lane] = bs; TM[lane] = fmaxf(mcar, pm); }
    WG_BARRIER();
    const int q = j0 + r32; const float Mq = TM[q], bq = TB[q]; const float inter = __expf(mcar - Mq), emq = __expf(-bq - Mq), Mq2 = Mq * LOG2E;
    bf16x8 qr[8];
#pragma unroll
    for (int d0 = 0; d0 < 8; ++d0) qr[d0] = *(const bf16x8*)(T.MQ + (row0 + q) * MLW + h * 128 + d0 * 16 + hi * 8);
    f32x16 p0 = {}, p1 = {};
    { lds_cptr kb[4];
#pragma unroll
      for (int dd = 0; dd < 4; ++dd) kb[dd] = lds + L_KI + h * 16384 + KSWZ(r32, (dd * 16 + hi * 8) * 2);
#pragma unroll
      for (int d0 = 0; d0 < 8; ++d0) { lds_cptr a = kb[d0 & 3] + (d0 >> 2) * 128; const bf16x8 b0 = *(const LAS bf16x8*)a, b1 = *(const LAS bf16x8*)(a + 32 * 256);
          p0 = __builtin_amdgcn_mfma_f32_32x32x16_bf16(b0, qr[d0], p0, 0, 0, 0); p1 = __builtin_amdgcn_mfma_f32_32x32x16_bf16(b1, qr[d0], p1, 0, 0, 0); } }
    float ps = 0.f;
#pragma unroll
    for (int r = 0; r < 16; ++r) { const int k0 = crow(r, hi), k1 = 32 + k0;
        const float d0 = (k0 <= q) ? __builtin_amdgcn_exp2f(TU2[k0] - Mq2) : 0.f, d1 = (k1 <= q) ? __builtin_amdgcn_exp2f(TU2[k1] - Mq2) : 0.f;
        p0[r] *= d0; p1[r] *= d1; ps += p0[r] + p1[r]; }
    ps = half_swap_add(ps);
    bf16x8 pa0, pa1, pa2, pa3;
    MK_PK4(p0, 0, pa0); MK_PK4(p0, 8, pa1); MK_PK4(p1, 0, pa2); MK_PK4(p1, 8, pa3);
    f32x16 o[4] = {};
    att::pv_tile(o, lds + L_VI + h * 16384 + v_rd_base(lane), pa0, pa1, pa2, pa3);
    float qn = 0.f; bf16x8 qs[8];
    { const float* nrow = T.NS + ((size_t)item * 4 + h) * 128;
#pragma unroll
      for (int d0 = 0; d0 < 8; ++d0) { float y[8]; unpack8(__builtin_bit_cast(u32x4, qr[d0]), y); const f32x4 n0 = *(const f32x4*)(nrow + d0 * 16 + hi * 8), n1 = *(const f32x4*)(nrow + d0 * 16 + hi * 8 + 4);
#pragma unroll
          for (int e = 0; e < 4; ++e) { qn += y[e] * n0[e] + y[4 + e] * n1[e]; }
#pragma unroll
          for (int e = 0; e < 8; ++e) y[e] *= inter;
          qs[d0] = __builtin_bit_cast(bf16x8, pack8f(y)); } }
    qn = half_swap_add(qn);
    { const bf16_t* cs = T.DC + ((size_t)item * 4 + h) * 16384;
#pragma unroll
      for (int vb = 0; vb < 4; ++vb)
#pragma unroll
          for (int ks = 0; ks < 8; ++ks) { const bf16x8 bfr = *(const bf16x8*)(cs + (size_t)(vb * 32 + r32) * 128 + ks * 16 + hi * 8); o[vb] = __builtin_amdgcn_mfma_f32_32x32x16_bf16(qs[ks], bfr, o[vb], 0, 0, 0); } }
    const float den = ps + inter * qn; const float inv = 1.0f / fmaxf(fabsf(den), emq);
    if (hi == 0) SC[r32] = inv; LGKM0();
    const float gn0 = T.gnorm[h * 128 + r32], gn1 = T.gnorm[h * 128 + 32 + r32], gn2 = T.gnorm[h * 128 + 64 + r32], gn3 = T.gnorm[h * 128 + 96 + r32];
#pragma unroll
    for (int r = 0; r < 16; ++r) { const int orow = crow(r, hi); const float ri = SC[orow];
        float hv[4]; float ss = 0.f;
#pragma unroll
        for (int d0 = 0; d0 < 4; ++d0) { hv[d0] = o[d0][r] * ri; ss += hv[d0] * hv[d0]; }
        ss += __shfl_xor(ss, 1); ss += __shfl_xor(ss, 2); ss += __shfl_xor(ss, 4); ss += __shfl_xor(ss, 8); ss += __shfl_xor(ss, 16);
        const float rstd = __builtin_amdgcn_rsqf(ss * (1.0f / 128.0f) + EPS);
        const size_t grow = row0 + j0 + orow; const bf16_t* mo = T.ZM + grow * 2048 + 1536 + h * 128; bf16_t* op = T.MIX + grow * DM + 512 + h * 128;
        const float gsel[4] = {gn0, gn1, gn2, gn3};
#pragma unroll
        for (int d0 = 0; d0 < 4; ++d0) { const float mv = __uint_as_float((unsigned)mo[d0 * 32 + r32] << 16); const float v = hv[d0] * rstd * gsel[d0] * sigmoid_f(mv); const float vn = __shfl_xor(v, 1);
            if ((r32 & 1) == 0) *(unsigned*)(op + d0 * 32 + r32) = cvtpk(v, vn); } }
    WG_BARRIER();
}
#undef KSWZ
}

#ifndef MK_N_LAUNCHES
#define MK_N_LAUNCHES 12
#endif
constexpr int NWAVES = 8;
constexpr int N_PHASES = 12;
constexpr int N_LAUNCHES = MK_N_LAUNCHES;

constexpr size_t MiB = 1u << 20;
constexpr size_t WS_CTL = 0, CTL_ZERO_BYTES = 64 * 1024;
constexpr size_t WS_WIN = 1 * MiB;
constexpr size_t WS_WUQ = 6 * MiB;
constexpr size_t WS_WUKV = 6 * MiB + 512 * 1024;
constexpr size_t WS_WOUT = 7 * MiB;
constexpr size_t WS_WGU = 9 * MiB;
constexpr size_t WS_WDN = 20 * MiB;
constexpr size_t WS_WPG = 26 * MiB;
constexpr size_t WS_WPP = 28 * MiB;
constexpr size_t WS_RC = 29 * MiB, WS_RS = 33 * MiB;
constexpr size_t WS_GATE = 37 * MiB;
constexpr size_t WS_GG = 38 * MiB, WS_ML = 38 * MiB + 64 * 1024, WS_MS = 38 * MiB + 128 * 1024;
constexpr size_t WS_DN = 39 * MiB, WS_NS = 40 * MiB;
constexpr size_t WS_XN = 48 * MiB;
constexpr size_t WS_DC = 48 * MiB;
constexpr size_t WS_MIX = 48 * MiB;
constexpr size_t WS_F = 48 * MiB;
constexpr size_t WS_ZM = 112 * MiB;
constexpr size_t WS_FN = 112 * MiB;
constexpr size_t WS_H2B = 112 * MiB;
constexpr size_t WS_PP = 176 * MiB;
constexpr size_t WS_ZA = 240 * MiB;
constexpr size_t WS_ZAF = 272 * MiB;
constexpr size_t WS_MIXIN = 240 * MiB;
constexpr size_t WS_QB = 304 * MiB;
constexpr size_t WS_KB = 352 * MiB;
constexpr size_t WS_VB = 400 * MiB;
constexpr size_t WS_MQ = 432 * MiB, WS_MK = 464 * MiB;
constexpr size_t WS_ACT = 304 * MiB;
constexpr size_t WS_PB = 496 * MiB;
constexpr size_t WS_END = 512 * MiB;
static_assert(WS_ACT + (size_t)MTOK * DFF * 2 <= WS_PB && WS_MK + (size_t)MTOK * 512 * 2 <= WS_PB && WS_ZAF + (size_t)MTOK * 128 * 4 <= WS_QB && WS_MIXIN + (size_t)MTOK * DM * 2 <= WS_QB, "d_ws map");
static_assert(WS_ZM + (size_t)MTOK * 2048 * 2 <= WS_ZA && WS_PP + (size_t)MTOK * DM * 2 <= WS_ZA && WS_XN + (size_t)MTOK * DM * 2 <= WS_ZM && WS_NS + 1 * MiB <= WS_XN, "d_ws map");

constexpr int RING_OFF = 0, RING_BYTES = 131072;
constexpr int MISC_OFF = RING_BYTES, MISC_BYTES = 12288;
constexpr int LDSCTL_OFF = MISC_OFF + MISC_BYTES;
constexpr int LDS_BYTES = 147456;
static_assert(LDSCTL_OFF + 128 <= LDS_BYTES && att::L_END <= RING_BYTES, "LDS map");

#define GAS __attribute__((address_space(1)))
#define LAS __attribute__((address_space(3)))
typedef unsigned short bf16;
typedef unsigned v4u __attribute__((ext_vector_type(4)));
typedef float f32x4 __attribute__((ext_vector_type(4)));
typedef short bf16x8 __attribute__((ext_vector_type(8)));
typedef GAS unsigned gu32;
typedef GAS unsigned long long gu64;
#define RLX_AGENT __ATOMIC_RELAXED, __HIP_MEMORY_SCOPE_AGENT
#define LDS_WAIT() asm volatile("s_waitcnt lgkmcnt(0)" ::: "memory")
#define VM_WAIT() asm volatile("s_waitcnt vmcnt(0)" ::: "memory")
__device__ __forceinline__ unsigned long long rt() { return __builtin_amdgcn_s_memrealtime(); }
__device__ __forceinline__ unsigned f2bf(float f) { unsigned u = __builtin_bit_cast(unsigned, f); return (u + 0x7fffu + ((u >> 16) & 1u)) >> 16; }
__device__ __forceinline__ unsigned pk2(float lo, float hi) { return f2bf(lo) | (f2bf(hi) << 16); }

#define XB_TMO      128
#define XB_XCNT(j)  (256  + 64 * (j))
#define XB_XSUB(j)  (1280 + 64 * (j))
#define XB_XGEN(j)  (2304 + 64 * (j))
#define XB_TOP      3328
#define XB_TOPGEN   3392
#define XCD_BAR_WORDS 3456
#define XB_SPIN_CAP (1u << 18)

__device__ __forceinline__ unsigned xb_ld(unsigned* p)              { return __hip_atomic_load(p, __ATOMIC_RELAXED, __HIP_MEMORY_SCOPE_AGENT); }
__device__ __forceinline__ unsigned xb_add(unsigned* p, unsigned v) { return __hip_atomic_fetch_add(p, v, __ATOMIC_RELAXED, __HIP_MEMORY_SCOPE_AGENT); }
__device__ __forceinline__ unsigned xb_xcc_id() { return (unsigned)__builtin_amdgcn_s_getreg((3 << 11) | 20) & 0xFu; }
#define XB_SPIN(cond, bar) do { unsigned _sp = 0; while (cond) { __builtin_amdgcn_s_sleep(1); \
    if ((++_sp & 255u) == 0u) { if (xb_ld(&(bar)[XB_TMO])) break; if (_sp > XB_SPIN_CAP) { atomicAdd(&(bar)[XB_TMO], 1u); break; } } } } while (0)

struct XcdBarrier {
    unsigned* bar; unsigned x;
    volatile LAS unsigned* st;
};

__device__ __forceinline__ XcdBarrier xcd_barrier_post(unsigned* bar, volatile LAS unsigned* st) {
    XcdBarrier b; b.bar = bar; b.x = xb_xcc_id(); b.st = st;
    if (threadIdx.x == 0) (void)xb_add(&bar[XB_XCNT(b.x)], 1u);
    return b;
}
__device__ __forceinline__ void xcd_barrier_complete(unsigned* bar, unsigned x, unsigned& nloc, unsigned& nx) {
    const unsigned G = gridDim.x * gridDim.y * gridDim.z;
    unsigned sum, cnt, mine, sp = 0u;
    for (;;) {
        sum = 0u; cnt = 0u; mine = 0u;
#pragma unroll
        for (unsigned j = 0; j < 16; ++j) { const unsigned c = xb_ld(&bar[XB_XCNT(j)]); sum += c; cnt += (c > 0u) ? 1u : 0u; mine = (j == x) ? c : mine; }
        if (sum == G) break;
        __builtin_amdgcn_s_sleep(1);
        if ((++sp & 255u) == 0u) { if (xb_ld(&bar[XB_TMO])) break; if (sp > XB_SPIN_CAP) { atomicAdd(&bar[XB_TMO], 1u); break; } }
    }
    nloc = mine > 0u ? mine : 1u; nx = cnt > 0u ? cnt : 1u;
}

__device__ __forceinline__ void xcd_barrier(const XcdBarrier& b) {
    asm volatile("s_waitcnt vmcnt(0)" ::: "memory");
    __syncthreads();
    if (threadIdx.x == 0) {
        unsigned* bar = b.bar;
        __builtin_amdgcn_s_waitcnt(0);
        unsigned nloc = b.st[0], nx = b.st[1];
        if (nloc == 0u) { xcd_barrier_complete(bar, b.x, nloc, nx); b.st[0] = nloc; b.st[1] = nx; }
        const unsigned old = xb_add(&bar[XB_XSUB(b.x)], 1u);
        const unsigned gen = old / nloc;
        if (old + 1u == (gen + 1u) * nloc) {
            __builtin_amdgcn_fence(__ATOMIC_RELEASE, "agent");
            asm volatile("s_waitcnt vmcnt(0)" ::: "memory");
            const unsigned og = xb_add(&bar[XB_TOP], 1u);
            const unsigned tg = og / nx;
            if (og + 1u == (tg + 1u) * nx) xb_add(&bar[XB_TOPGEN], 1u);
            else XB_SPIN(xb_ld(&bar[XB_TOPGEN]) == tg, bar);
            __builtin_amdgcn_fence(__ATOMIC_ACQUIRE, "agent");
            xb_add(&bar[XB_XGEN(b.x)], 1u);
            asm volatile("s_waitcnt vmcnt(0)" ::: "memory");
        } else {
            XB_SPIN(xb_ld(&bar[XB_XGEN(b.x)]) == gen, bar);
            __builtin_amdgcn_fence(__ATOMIC_ACQUIRE, "agent");
            asm volatile("s_waitcnt vmcnt(0)" ::: "memory");
        }
    }
    __syncthreads();
}

struct Frame {
    LAS unsigned char* lds;
    gu32* ctl;
    int tid, lane, wave, vcu, G;
    unsigned char* ws; float* out;
};
struct Args { const void* in[23]; float* out; unsigned char* ws; int ph_lo, ph_hi; };
__device__ __forceinline__ int opaque_zero() { int z; asm volatile("s_mov_b32 %0, 0" : "=s"(z)); return z; }
template <class T> __device__ __forceinline__ const T* inp(const Args& a, int i, int z) { return (const T*)a.in[i + z]; }
struct WPtrs { const float *w_in, *w_uq, *w_ukv, *w_out, *w_gate, *w_up, *w_down, *w_pp, *w_pg; };
template <class T> __device__ __forceinline__ T* wsp(const Frame& F, size_t off) { return (T*)(F.ws + off); }

__device__ __forceinline__ float wave_sum(float v) {
#pragma unroll
    for (int o = 1; o < 64; o <<= 1) v += __shfl_xor(v, o);
    return v;
}
__device__ __forceinline__ float wsrc(const WPtrs& F, int mat, int k, int n) {
    switch (mat) {
    case 0: { int src;
        if (n < 384) src = n; else if (n < 448) { const int j = n - 384; src = 384 + 32 * (j & 1) + (j >> 1); } else if (n < 456) src = 2496 + (n - 448); else if (n < 512) return 0.f; else src = 448 + (n - 512);
        return F.w_in[(size_t)k * DIN + src]; }
    case 1: { const int h = n / QKD, j = n - h * QKD; const int src = (j < 128) ? h * QKD + j : h * QKD + 128 + 32 * ((j - 128) & 1) + ((j - 128) >> 1);
        return F.w_uq[(size_t)k * 768 + src]; }
    case 2: return k < 128 ? F.w_ukv[(size_t)k * 1024 + n] : 0.f;
    case 3: return F.w_out[(size_t)k * DM + n];
    case 4: { const int t = n >> 8, e = (n >> 7) & 1, j = n & 127; const float* w = e ? F.w_up : F.w_gate; return w[(size_t)k * DFF + t * 128 + j]; }
    case 5: return F.w_down[(size_t)k * DM + n];
    case 6: return F.w_pg[(size_t)k * DM + n];
    default: return F.w_pp[(size_t)k * DM + n];
    }
}
__device__ __forceinline__ void p0_transpose_item(const WPtrs& F, int mat, int K, bf16* WT, int k0, int n0, LAS float* scr, int lane) {
#pragma unroll 8
    for (int i = 0; i < 32; ++i) { const int kk = 2 * i + (lane >> 5); scr[kk * 33 + (lane & 31)] = wsrc(F, mat, k0 + kk, n0 + (lane & 31)); }
    LDS_WAIT(); asm volatile("" ::: "memory");
    const int c = lane & 7;
#pragma unroll
    for (int j = 0; j < 4; ++j) { const int n = (lane >> 3) + 8 * j; const LAS float* s = scr + (8 * c) * 33 + n;
        v4u o; o.x = pk2(s[0 * 33], s[1 * 33]); o.y = pk2(s[2 * 33], s[3 * 33]); o.z = pk2(s[4 * 33], s[5 * 33]); o.w = pk2(s[6 * 33], s[7 * 33]);
        *(GAS v4u*)(WT + (size_t)(n0 + n) * K + k0 + 8 * c) = o; }
    LDS_WAIT(); asm volatile("" ::: "memory");
}
__device__ __forceinline__ void p0_prologue(Frame& F, const Args& args) {
    const int z = opaque_zero();
    WPtrs W; W.w_in = inp<float>(args, 5, z); W.w_uq = inp<float>(args, 8, z); W.w_ukv = inp<float>(args, 9, z); W.w_out = inp<float>(args, 15, z); W.w_gate = inp<float>(args, 18, z); W.w_up = inp<float>(args, 19, z);
    W.w_down = inp<float>(args, 20, z); W.w_pp = inp<float>(args, 21, z); W.w_pg = inp<float>(args, 22, z);
    const float* x = inp<float>(args, 0, z); const float* pp_in = inp<float>(args, 1, z); const int* pos = inp<int>(args, 2, z); const float* g_attn_pre = inp<float>(args, 3, z);
    LAS float* scr = (LAS float*)(F.lds + RING_OFF + F.wave * 8448);
    const int gw = F.vcu * NWAVES + F.wave, NGW = F.G * NWAVES;
    constexpr int NM = 8;
    const int mK[NM] = {1024, 256, 256, 1024, 1024, DFF, 1024, 256}, mN[NM] = {NZ, 768, 1024, 1024, 2 * DFF, 1024, 1024, 1024};
    const size_t mO[NM] = {WS_WIN, WS_WUQ, WS_WUKV, WS_WOUT, WS_WGU, WS_WDN, WS_WPG, WS_WPP};
    int start = 0;
#pragma unroll
    for (int m = 0; m < NM; ++m) { const int nkb = mK[m] / 64, nnb = mN[m] / 32, cnt = nkb * nnb;
        int it = start + ((gw - start % NGW) + NGW) % NGW;
        for (; it < start + cnt; it += NGW) { const int r = it - start, kb = r / nnb, nb = r - kb * nnb; p0_transpose_item(W, m, mK[m], wsp<bf16>(F, mO[m]), 64 * kb, 32 * nb, scr, F.lane); }
        start += cnt; }
    bf16* XN = wsp<bf16>(F, WS_XN); bf16* PB = wsp<bf16>(F, WS_PB); float* RC = wsp<float>(F, WS_RC); float* RS = wsp<float>(F, WS_RS);
    const float inv_freq = (float)pow(10000.0, -(double)(F.lane & 31) / 32.0);
    for (int m = gw; m < MTOK; m += NGW) {
        const GAS f32x4* xr = (const GAS f32x4*)(x + (size_t)m * DM) + F.lane; f32x4 v[4]; float s = 0.f;
#pragma unroll
        for (int j = 0; j < 4; ++j) { v[j] = xr[64 * j]; s += (v[j].x * v[j].x + v[j].y * v[j].y) + (v[j].z * v[j].z + v[j].w * v[j].w); }
        const float rstd = 1.0f / sqrtf(wave_sum(s) * (1.f / DM) + EPS);
        GAS unsigned long long* o8 = (GAS unsigned long long*)(XN + (size_t)m * DM) + F.lane;
#pragma unroll
        for (int j = 0; j < 4; ++j) { const f32x4 g = *((const GAS f32x4*)g_attn_pre + F.lane + 64 * j);
            o8[64 * j] = (unsigned long long)pk2(v[j].x * rstd * g.x, v[j].y * rstd * g.y) | ((unsigned long long)pk2(v[j].z * rstd * g.z, v[j].w * rstd * g.w) << 32); }
        { const f32x4 pv = *((const GAS f32x4*)(pp_in + (size_t)m * PLE) + F.lane);
          *((GAS unsigned long long*)(PB + (size_t)m * PLE) + F.lane) = (unsigned long long)pk2(pv.x, pv.y) | ((unsigned long long)pk2(pv.z, pv.w) << 32); }
        { const float ang = (float)pos[m] * inv_freq; const double a = (double)ang;
          if (F.lane < 32) RC[(size_t)m * 32 + F.lane] = (float)cos(a); else RS[(size_t)m * 32 + (F.lane - 32)] = (float)sin(a); }
    }
}
__device__ __forceinline__ float log_sigmoid_f(float x) { return fminf(x, 0.f) - log1pf(__expf(-fabsf(x))); }
__device__ __forceinline__ void p2_rows(Frame& F, const Args& args) {
    const int z = opaque_zero(); const float* g_q = inp<float>(args, 6, z); const float* g_kv = inp<float>(args, 7, z); const float* bias_i = inp<float>(args, 12, z); const float* bias_f = inp<float>(args, 13, z);
    const int gw = F.vcu * NWAVES + F.wave, NGW = F.G * NWAVES, lane = F.lane;
    bf16* ZA = wsp<bf16>(F, WS_ZA); const float* ZAF = wsp<float>(F, WS_ZAF); bf16* KB = wsp<bf16>(F, WS_KB); float* GATE = wsp<float>(F, WS_GATE);
    const float* RC = wsp<float>(F, WS_RC); const float* RS = wsp<float>(F, WS_RS);
    const f32x4 gq = *((const GAS f32x4*)g_q + lane); const float gk0 = g_kv[2 * lane], gk1 = g_kv[2 * lane + 1];
    for (int m = gw; m < MTOK; m += NGW) {
        bf16* zr = ZA + (size_t)m * 512;
        const unsigned long long cq = *((const GAS unsigned long long*)zr + lane); const unsigned ckv = *((const GAS unsigned*)(zr + 256) + lane);
        const float q0 = mk::bflo((unsigned)cq), q1 = mk::bfhi((unsigned)cq), q2 = mk::bflo((unsigned)(cq >> 32)), q3 = mk::bfhi((unsigned)(cq >> 32)), k0 = mk::bflo(ckv), k1 = mk::bfhi(ckv);
        const float rq = 1.0f / sqrtf(wave_sum((q0 * q0 + q1 * q1) + (q2 * q2 + q3 * q3)) * (1.f / 256.f) + EPS);
        const float rk = 1.0f / sqrtf(wave_sum(k0 * k0 + k1 * k1) * (1.f / 128.f) + EPS);
        *((GAS unsigned long long*)zr + lane) = (unsigned long long)pk2(q0 * rq * gq.x, q1 * rq * gq.y) | ((unsigned long long)pk2(q2 * rq * gq.z, q3 * rq * gq.w) << 32);
        *((GAS unsigned*)(zr + 256) + lane) = pk2(k0 * rk * gk0, k1 * rk * gk1);
        const float* zf = ZAF + (size_t)m * 128; const int b = m >> 13, s = m & (SEQ - 1);
        if (lane < 32) { const float t1 = zf[2 * lane], t2 = zf[2 * lane + 1], c = RC[(size_t)m * 32 + lane], sn = RS[(size_t)m * 32 + lane];
            const unsigned w = pk2(t1 * c - t2 * sn, t2 * c + t1 * sn);
#pragma unroll
            for (int h = 0; h < NHD; ++h) *(GAS unsigned*)(KB + ((size_t)(b * NHD + h) * SEQ + s) * QKD + 128 + 2 * lane) = w; }
        else if (lane < 40) { const int g = lane - 32; const float v = zf[64 + g];
            GATE[(size_t)m * 8 + g] = (g < 4) ? v + bias_i[g] : log_sigmoid_f(v + bias_f[g - 4]); }
    }
}
__device__ __forceinline__ void resid_rows(Frame& F, const bf16* Y, const float* base, float* out, bf16* NB, const float* gy, const float* gn) {
    const int gw = F.vcu * NWAVES + F.wave, NGW = F.G * NWAVES, lane = F.lane;
    float gyv[16], gnv[16];
#pragma unroll
    for (int j = 0; j < 2; ++j)
#pragma unroll
        for (int e = 0; e < 8; ++e) { gyv[j * 8 + e] = gy[j * 512 + lane * 8 + e]; gnv[j * 8 + e] = gn ? gn[j * 512 + lane * 8 + e] : 1.f; }
    for (int m = gw; m < MTOK; m += NGW) {
        float y[16], h[16]; float ss = 0.f;
#pragma unroll
        for (int j = 0; j < 2; ++j) { const v4u w = *(const GAS v4u*)(Y + (size_t)m * DM + j * 512 + lane * 8); mk::unpack8(w, y + 8 * j);
            const f32x4 b0 = *(const GAS f32x4*)(base + (size_t)m * DM + j * 512 + lane * 8), b1 = *(const GAS f32x4*)(base + (size_t)m * DM + j * 512 + lane * 8 + 4);
#pragma unroll
            for (int e = 0; e < 4; ++e) { h[8 * j + e] = b0[e]; h[8 * j + 4 + e] = b1[e]; } }
#pragma unroll
        for (int e = 0; e < 16; ++e) ss += y[e] * y[e];
        const float ry = 1.0f / sqrtf(wave_sum(ss) * (1.f / DM) + EPS); float s2 = 0.f;
#pragma unroll
        for (int e = 0; e < 16; ++e) { h[e] += y[e] * ry * gyv[e]; s2 += h[e] * h[e]; }
        const float rh = gn ? 1.0f / sqrtf(wave_sum(s2) * (1.f / DM) + EPS) : 1.f;
#pragma unroll
        for (int j = 0; j < 2; ++j) { float* op = out + (size_t)m * DM + j * 512 + lane * 8;
            *(GAS f32x4*)op = (f32x4){h[8 * j], h[8 * j + 1], h[8 * j + 2], h[8 * j + 3]}; *(GAS f32x4*)(op + 4) = (f32x4){h[8 * j + 4], h[8 * j + 5], h[8 * j + 6], h[8 * j + 7]};
            float nv[8];
#pragma unroll
            for (int e = 0; e < 8; ++e) nv[e] = h[8 * j + e] * rh * gnv[8 * j + e];
            *(GAS v4u*)(NB + (size_t)m * DM + j * 512 + lane * 8) = mk::pack8f(nv); }
    }
}

__global__ void __launch_bounds__(NWAVES * 64, 2) hymba_fwd(Args args) {
    extern __shared__ __attribute__((aligned(16))) unsigned char lds[];
    Frame F;
    F.lds = (LAS unsigned char*)lds;
    F.tid = threadIdx.x; F.lane = F.tid & 63; F.wave = __builtin_amdgcn_readfirstlane(F.tid >> 6);
    F.G = gridDim.x; { const int bx = blockIdx.x; F.vcu = (F.G % 8 == 0) ? (bx % 8) * (F.G / 8) + bx / 8 : bx; }
    F.ws = args.ws; F.out = args.out; F.ctl = (gu32*)(args.ws + WS_CTL);
    for (int u = F.tid; u < (LDS_BYTES - LDSCTL_OFF) / 4; u += NWAVES * 64) ((LAS unsigned*)(F.lds + LDSCTL_OFF))[u] = 0u;
    __syncthreads();
    volatile LAS unsigned* CTLW = (volatile LAS unsigned*)(F.lds + LDSCTL_OFF);
    XcdBarrier bar; bar.bar = (unsigned*)F.ctl; bar.x = 0; bar.st = nullptr;
    if (N_LAUNCHES == 1) bar = xcd_barrier_post((unsigned*)F.ctl, CTLW + 8);
    const int lo = args.ph_lo, hi = args.ph_hi;
#ifndef PH_MASK
#define PH_MASK 0xFFF
#endif
#define IN(k) (((PH_MASK >> (k)) & 1) && lo <= (k) && (k) < hi)
#define SEAM(k) do { if (IN(k) && IN((k) + 1)) xcd_barrier(bar); } while (0)
    LAS unsigned char* ring = F.lds + RING_OFF; LAS unsigned char* misc = F.lds + MISC_OFF;
    ml::Tens MT; MT.ZM = wsp<bf16>(F, WS_ZM); MT.GATE = wsp<float>(F, WS_GATE); MT.conv_w = nullptr; MT.conv_b = nullptr; MT.gnorm = nullptr; MT.MQ = wsp<bf16>(F, WS_MQ); MT.MK = wsp<bf16>(F, WS_MK);
    MT.DC = wsp<bf16>(F, WS_DC); MT.DN = wsp<float>(F, WS_DN); MT.NS = wsp<float>(F, WS_NS); MT.GG = wsp<float>(F, WS_GG); MT.ML = wsp<float>(F, WS_ML); MT.MS = wsp<float>(F, WS_MS); MT.MIX = wsp<bf16>(F, WS_MIXIN);
    const int bx = (int)blockIdx.x;

    if (IN(0)) { p0_prologue(F, args); } SEAM(0);
    if (IN(1)) { pg8::Gemm g{wsp<bf16>(F, WS_XN), wsp<bf16>(F, WS_WIN), MTOK, NZ, DM, DM}; pg8::StaticOrder S; S.init(MTOK, NZ, F.G, bx);
        pg8::EpiZ E{wsp<bf16>(F, WS_ZA), wsp<bf16>(F, WS_ZM), wsp<float>(F, WS_ZAF)};
        pg8::gemm_phase<pg8::EpiZ, pg8::StaticOrder, true, true>(ring, g, S, E); } SEAM(1);
    if (IN(2)) { p2_rows(F, args); } SEAM(2);
    if (IN(3)) {
#ifndef SUBM
#define SUBM 7
#endif
        if (SUBM & 1) { pg8::Gemm g{wsp<bf16>(F, WS_ZA), wsp<bf16>(F, WS_WUQ), MTOK, 768, 256, 512}; pg8::StaticOrder S; S.init(MTOK, 768, F.G, bx);
          pg8::EpiQ E{wsp<bf16>(F, WS_QB), wsp<float>(F, WS_RC), wsp<float>(F, WS_RS), QSCALE};
          pg8::gemm_phase<pg8::EpiQ, pg8::StaticOrder, true, true>(ring, g, S, E); }
        if (SUBM & 2) { pg8::Gemm g{wsp<bf16>(F, WS_ZA) + 256, wsp<bf16>(F, WS_WUKV), MTOK, 1024, 256, 512}; pg8::StaticOrder S; S.init(MTOK, 1024, F.G, bx);
          pg8::EpiKV E{wsp<bf16>(F, WS_KB), wsp<bf16>(F, WS_VB)};
          pg8::gemm_phase<pg8::EpiKV, pg8::StaticOrder, true, true>(ring, g, S, E); }
        { const int z = opaque_zero(); MT.conv_w = inp<float>(args, 10, z); MT.conv_b = inp<float>(args, 11, z); }
        if (SUBM & 4) for (int it = F.vcu; it < BATCH * NCH; it += F.G) ml::pass_a(MT, it, ring, misc);
    } SEAM(3);
    if (IN(4)) { for (int v = F.vcu; v < 256; v += F.G) ml::pass_b(MT, v, misc); } SEAM(4);
    if (IN(5)) {
        if (SUBM & 1) for (int v = F.vcu; v < 256; v += F.G) { const int bh = v >> 4, s = v & 15, b = bh >> 2, h = bh & 3;
            att::attn_unit(b, h, 31 - s, wsp<bf16>(F, WS_QB), wsp<bf16>(F, WS_KB), wsp<bf16>(F, WS_VB), wsp<bf16>(F, WS_MIXIN), ring);
            att::attn_unit(b, h, s, wsp<bf16>(F, WS_QB), wsp<bf16>(F, WS_KB), wsp<bf16>(F, WS_VB), wsp<bf16>(F, WS_MIXIN), ring); }
        { const int z = opaque_zero(); MT.gnorm = inp<float>(args, 14, z); }
        if (SUBM & 2) for (int it = F.vcu; it < BATCH * NCH; it += F.G) ml::pass_c(MT, it, ring, misc);
    } SEAM(5);
    if (IN(6)) { pg8::Gemm g{wsp<bf16>(F, WS_MIXIN), wsp<bf16>(F, WS_WOUT), MTOK, DM, DM, DM}; pg8::StaticOrder S; S.init(MTOK, DM, F.G, bx);
        pg8::EpiStore E{wsp<bf16>(F, WS_MIX), DM};
        pg8::gemm_phase<pg8::EpiStore, pg8::StaticOrder, true, true>(ring, g, S, E); } SEAM(6);
    if (IN(7)) { const int z = opaque_zero(); resid_rows(F, wsp<bf16>(F, WS_MIX), inp<float>(args, 0, z), F.out, wsp<bf16>(F, WS_FN), inp<float>(args, 4, z), inp<float>(args, 16, z)); } SEAM(7);
    if (IN(8)) { pg8::Gemm g{wsp<bf16>(F, WS_FN), wsp<bf16>(F, WS_WGU), MTOK, 2 * DFF, DM, DM}; pg8::StaticOrder S; S.init(MTOK, 2 * DFF, F.G, bx);
        pg8::EpiGU E{wsp<bf16>(F, WS_ACT)};
        pg8::gemm_phase<pg8::EpiGU, pg8::StaticOrder, true, true>(ring, g, S, E); } SEAM(8);
    if (IN(9)) { pg8::Gemm g{wsp<bf16>(F, WS_ACT), wsp<bf16>(F, WS_WDN), MTOK, DM, DFF, DFF}; pg8::StaticOrder S; S.init(MTOK, DM, F.G, bx);
        pg8::EpiStore E{wsp<bf16>(F, WS_F), DM};
        pg8::gemm_phase<pg8::EpiStore, pg8::StaticOrder, true, true>(ring, g, S, E); } SEAM(9);
    if (IN(10)) { const int z = opaque_zero(); resid_rows(F, wsp<bf16>(F, WS_F), F.out, F.out, wsp<bf16>(F, WS_H2B), inp<float>(args, 17, z), nullptr); } SEAM(10);
    if (IN(11)) {
        if (SUBM & 1) { pg8::Gemm g{wsp<bf16>(F, WS_PB), wsp<bf16>(F, WS_WPP), MTOK, DM, PLE, PLE}; pg8::StaticOrder S; S.init(MTOK, DM, F.G, bx);
          pg8::EpiStore E{wsp<bf16>(F, WS_PP), DM};
          pg8::gemm_phase<pg8::EpiStore, pg8::StaticOrder, true, true>(ring, g, S, E); }
        if (SUBM & 2) { pg8::Gemm g{wsp<bf16>(F, WS_H2B), wsp<bf16>(F, WS_WPG), MTOK, DM, DM, DM}; pg8::StaticOrder S; S.init(MTOK, DM, F.G, bx);
          pg8::EpiFin E{F.out, wsp<bf16>(F, WS_PP)};
          pg8::gemm_phase<pg8::EpiFin, pg8::StaticOrder, true, true>(ring, g, S, E); }
    }
#undef IN
#undef SEAM
}

extern "C" void kernel_launch(void* const* d_in, const int* in_sizes, int n_in, void* d_out, int out_size, void* d_ws, size_t ws_size, hipStream_t stream) {
    static int grid = 0;
    if (grid == 0) {
        if (n_in != 23 || in_sizes[0] != MTOK * DM || out_size != MTOK * DM || ws_size < WS_END) {
            fprintf(stderr, "kernel_launch: built for 23 inputs, x/out of %d floats, >= %zu bytes of workspace; got n_in %d, in0 %d, out %d, ws %zu; nothing launched\n", MTOK * DM, (size_t)WS_END, n_in, n_in > 0 ? in_sizes[0] : -1, out_size, ws_size);
            grid = -1; return; }
        int dev = 0, cus = 0, per_cu = 0;
        if (hipGetDevice(&dev) != hipSuccess || hipDeviceGetAttribute(&cus, hipDeviceAttributeMultiprocessorCount, dev) != hipSuccess) { fprintf(stderr, "kernel_launch: device query failed\n"); grid = -1; return; }
        if (hipFuncSetAttribute((const void*)hymba_fwd, hipFuncAttributeMaxDynamicSharedMemorySize, LDS_BYTES) != hipSuccess) { fprintf(stderr, "kernel_launch: hipFuncSetAttribute failed\n"); grid = -1; return; }
        if (hipOccupancyMaxActiveBlocksPerMultiprocessor(&per_cu, (const void*)hymba_fwd, NWAVES * 64, LDS_BYTES) != hipSuccess || per_cu < 1) {
            fprintf(stderr, "kernel_launch: occupancy query reports %d workgroups per CU\n", per_cu); per_cu = 1; }
        (void)hipGetLastError();
        grid = cus * 1;
        if (per_cu != 1) fprintf(stderr, "kernel_launch: note: occupancy query says %d per CU; launching one per CU\n", per_cu);
    }
    if (grid < 0) return;
    if (hipMemsetAsync((char*)d_ws + WS_CTL, 0, CTL_ZERO_BYTES, stream) != hipSuccess) { fprintf(stderr, "kernel_launch: hipMemsetAsync failed\n"); return; }
    Args a{};
    for (int i = 0; i < 23; ++i) a.in[i] = d_in[i];
    a.out = (float*)d_out; a.ws = (unsigned char*)d_ws;
    for (int li = 0; li < N_LAUNCHES; ++li) {
        if (N_LAUNCHES == 1) { a.ph_lo = 0; a.ph_hi = N_PHASES; } else { a.ph_lo = li; a.ph_hi = li + 1; }
        hipLaunchKernelGGL(hymba_fwd, dim3(grid), dim3(NWAVES * 64), LDS_BYTES, stream, a);
        const hipError_t le = hipPeekAtLastError();
        if (le != hipSuccess) { fprintf(stderr, "kernel_launch: launch %d failed: %s\n", li, hipGetErrorName(le)); break; }
    }
}
```
